# Optimizing an MI355X kernel written in HIP

```python
import math
import jax, jax.numpy as jnp
from jax import lax
import numpy as np

D_MODEL = 1024
BATCH = 16
SEQ = 2048
DEPTH = 1

N_ATTN_HEADS = 8
HEAD_DIM = 64
D_ATTN = N_ATTN_HEADS * HEAD_DIM
D_CONV = D_MODEL - D_ATTN
D_MIX = D_ATTN + D_CONV
D_IN_PROJ = 3 * D_ATTN + 2 * D_CONV
CONV_WIDTH = 31
D_FF = 4 * D_MODEL
DILATED_BRANCHES = ((128, 1), (512, 4), (2048, 16))
NUM_BUCKETS = 32
MAX_DISTANCE = 2048
RMS_EPS = 1e-6
LN_EPS = 1e-5
NEG_INF = -1e30

kernel_name = "hybrid_dilated_attn_conformer_conv_layer"


def rmsnorm(x, g):
    xf = x.astype(jnp.float32)
    y = xf * lax.rsqrt(jnp.mean(xf * xf, axis=-1, keepdims=True) + RMS_EPS)
    return (y * g.astype(jnp.float32)).astype(x.dtype)


def layernorm(x, g, b):
    xf = x.astype(jnp.float32)
    mu = jnp.mean(xf, axis=-1, keepdims=True)
    var = jnp.mean(jnp.square(xf - mu), axis=-1, keepdims=True)
    y = (xf - mu) * lax.rsqrt(var + LN_EPS)
    return (y * g.astype(jnp.float32) + b.astype(jnp.float32)).astype(x.dtype)


def t5_causal_bucket(distance):
    max_exact = NUM_BUCKETS // 2
    d = jnp.maximum(distance, 1).astype(jnp.float32)
    large = max_exact + (jnp.log(d / max_exact) / math.log(MAX_DISTANCE / max_exact)
                         * (NUM_BUCKETS - max_exact)).astype(jnp.int32)
    large = jnp.minimum(large, NUM_BUCKETS - 1)
    return jnp.where(distance < max_exact, distance, large)


def dilated_window_branch(q, k, v, rel_bias, window, dilation):
    B, S, H, hd = q.shape
    W = window // dilation
    L = S // dilation
    nb = -(-L // W)
    Lp = nb * W
    Bd = B * dilation

    def to_sub(t):
        return t.reshape(B, L, dilation, H, hd).transpose(0, 2, 3, 1, 4).reshape(Bd, H, L, hd)

    qs, ks, vs = to_sub(q), to_sub(k), to_sub(v)
    qb = jnp.pad(qs, ((0, 0), (0, 0), (0, Lp - L), (0, 0))).reshape(Bd, H, nb, W, hd)

    def key_blocks(t):
        t = jnp.pad(t, ((0, 0), (0, 0), (W, Lp - L), (0, 0))).reshape(Bd, H, nb + 1, W, hd)
        return jnp.concatenate([t[:, :, :-1], t[:, :, 1:]], axis=3)

    kb, vb = key_blocks(ks), key_blocks(vs)

    qi = jnp.arange(W, dtype=jnp.int32)[:, None]
    kc = jnp.arange(2 * W, dtype=jnp.int32)[None, :]
    dist = qi + W - kc
    blk = jnp.arange(nb, dtype=jnp.int32)[:, None, None]
    key_idx = blk * W + kc[None] - W
    valid = ((dist >= 0) & (dist <= W))[None] & (key_idx >= 0)
    bucket = t5_causal_bucket(jnp.clip(dist, 0, W) * dilation)
    bias = rel_bias[bucket].astype(jnp.float32).transpose(2, 0, 1)

    scale = 1.0 / math.sqrt(hd)
    s = jnp.einsum('zhnqd,zhnkd->zhnqk', qb, kb).astype(jnp.float32) * scale + bias[:, None]
    s = jnp.where(valid, s, NEG_INF)
    m = jnp.max(s, axis=-1)
    p = jnp.exp(s - m[..., None])
    l = jnp.sum(p, axis=-1)
    o = jnp.einsum('zhnqk,zhnkd->zhnqd', p, vb.astype(jnp.float32)) / l[..., None]

    o = o.reshape(Bd, H, Lp, hd)[:, :, :L].reshape(B, dilation, H, L, hd)
    o = o.transpose(0, 3, 1, 2, 4).reshape(B, S, H, hd)
    m = m.reshape(Bd, H, Lp)[:, :, :L].reshape(B, dilation, H, L).transpose(0, 3, 1, 2).reshape(B, S, H)
    l = l.reshape(Bd, H, Lp)[:, :, :L].reshape(B, dilation, H, L).transpose(0, 3, 1, 2).reshape(B, S, H)
    return o, m, l


def dilated_attention(q, k, v, rel_bias):
    outs = [dilated_window_branch(q, k, v, rel_bias, w, d) for (w, d) in DILATED_BRANCHES]
    m_all = outs[0][1]
    for _, m_i, _ in outs[1:]:
        m_all = jnp.maximum(m_all, m_i)
    num = 0.0
    den = 0.0
    for o_i, m_i, l_i in outs:
        w_i = l_i * jnp.exp(m_i - m_all)
        num = num + w_i[..., None] * o_i
        den = den + w_i
    return num / den[..., None]


def conformer_conv(a, gate, conv_w, conv_b, ln_g, ln_b):
    u = a * jax.nn.sigmoid(gate)
    y = lax.conv_general_dilated(
        u, conv_w[:, None, :], window_strides=(1,), padding=((CONV_WIDTH - 1, 0),),
        dimension_numbers=('NWC', 'WIO', 'NWC'), feature_group_count=D_CONV)
    y = y + conv_b
    y = layernorm(y, ln_g, ln_b)
    return jax.nn.silu(y)


def setup_inputs(seed: int = 0) -> dict:
    key = jax.random.key(seed)
    ks = jax.random.split(key, 14)
    f32 = jnp.float32
    x = jax.random.normal(ks[0], (BATCH, SEQ, D_MODEL), f32)
    norm1_g = 1.0 + 0.02 * jax.random.normal(ks[1], (DEPTH, D_MODEL), f32)
    w_in = jax.random.normal(ks[2], (DEPTH, D_MODEL, D_IN_PROJ), f32) * D_MODEL ** -0.5
    conv_w = jax.random.normal(ks[3], (DEPTH, CONV_WIDTH, D_CONV), f32) * CONV_WIDTH ** -0.5
    conv_b = 0.02 * jax.random.normal(ks[4], (DEPTH, D_CONV), f32)
    conv_ln_g = 1.0 + 0.02 * jax.random.normal(ks[5], (DEPTH, D_CONV), f32)
    conv_ln_b = 0.02 * jax.random.normal(ks[6], (DEPTH, D_CONV), f32)
    w_o = jax.random.normal(ks[7], (DEPTH, D_MIX, D_MODEL), f32) * D_MIX ** -0.5
    norm2_g = 1.0 + 0.02 * jax.random.normal(ks[8], (DEPTH, D_MODEL), f32)
    w_ff1 = jax.random.normal(ks[9], (DEPTH, D_MODEL, D_FF), f32) * D_MODEL ** -0.5
    w_ff2 = jax.random.normal(ks[10], (DEPTH, D_FF, D_MODEL), f32) * D_FF ** -0.5
    rel_bias = 0.5 * jax.random.normal(ks[11], (NUM_BUCKETS, N_ATTN_HEADS), f32)
    final_g = 1.0 + 0.02 * jax.random.normal(ks[12], (D_MODEL,), f32)
    return {"x": x, "norm1_g": norm1_g, "w_in": w_in, "conv_w": conv_w, "conv_b": conv_b,
            "conv_ln_g": conv_ln_g, "conv_ln_b": conv_ln_b, "w_o": w_o, "norm2_g": norm2_g,
            "w_ff1": w_ff1, "w_ff2": w_ff2, "rel_bias": rel_bias, "final_g": final_g}


def reference(x, norm1_g, w_in, conv_w, conv_b, conv_ln_g, conv_ln_b, w_o, norm2_g,
              w_ff1, w_ff2, rel_bias, final_g):
    B, S, _ = x.shape
    split_pts = [D_ATTN, 2 * D_ATTN, 3 * D_ATTN, 3 * D_ATTN + D_CONV]
    for layer in range(DEPTH):
        h = rmsnorm(x, norm1_g[layer])
        z = jnp.einsum('bsd,de->bse', h, w_in[layer])
        q, k, v, a, gate = jnp.split(z, split_pts, axis=-1)
        q = q.reshape(B, S, N_ATTN_HEADS, HEAD_DIM)
        k = k.reshape(B, S, N_ATTN_HEADS, HEAD_DIM)
        v = v.reshape(B, S, N_ATTN_HEADS, HEAD_DIM)
        attn = dilated_attention(q, k, v, rel_bias).astype(x.dtype).reshape(B, S, D_ATTN)
        conv = conformer_conv(a, gate, conv_w[layer], conv_b[layer],
                              conv_ln_g[layer], conv_ln_b[layer])
        mixed = jnp.concatenate([attn, conv], axis=-1)
        x = x + jnp.einsum('bse,ed->bsd', mixed, w_o[layer])
        h = rmsnorm(x, norm2_g[layer])
        f = jnp.square(jax.nn.relu(jnp.einsum('bsd,df->bsf', h, w_ff1[layer])))
        x = x + jnp.einsum('bsf,fd->bsd', f, w_ff2[layer])
    return rmsnorm(x, final_g)
```

```cpp
#include <hip/hip_runtime.h>
#include <cstdio>
#include <cstdint>

#ifndef N_LAUNCHES
#define N_LAUNCHES 7
#endif

#define LAS __attribute__((address_space(3)))
#define GAS __attribute__((address_space(1)))
typedef unsigned short bf16_t;
typedef short bf16x8 __attribute__((ext_vector_type(8)));
typedef short s16x4 __attribute__((ext_vector_type(4)));
typedef float f32x2 __attribute__((ext_vector_type(2)));
typedef float f32x4 __attribute__((ext_vector_type(4)));
typedef float f32x16 __attribute__((ext_vector_type(16)));
typedef unsigned u32x2 __attribute__((ext_vector_type(2)));
typedef unsigned u32x4 __attribute__((ext_vector_type(4)));
typedef __bf16 bf16x2_t __attribute__((ext_vector_type(2)));

constexpr int BATCH = 16, SEQ = 2048, DM = 1024, M = BATCH * SEQ;
constexpr int NH = 8, HD = 64, DA = 512, DC = 512, NIN = 3 * DA + 2 * DC, FF = 4096, CW = 31;
constexpr float RMS_EPS = 1e-6f, LN_EPS = 1e-5f, LOG2E = 1.4426950408889634f;
constexpr float QSCALE = 0.125f * LOG2E;

__device__ __forceinline__ unsigned cvtpk(float lo, float hi) { f32x2 v = {lo, hi}; bf16x2_t b = __builtin_convertvector(v, bf16x2_t); return __builtin_bit_cast(unsigned, b); }
__device__ __forceinline__ float bf2f(unsigned short h) { return __builtin_bit_cast(float, (unsigned)h << 16); }

namespace pg8 {
#define PG8_LAS __attribute__((address_space(3)))
constexpr int BM = 256, BK = 64, HALF = 128, HTB = HALF * BK * 2  , STAGE_BYTES = 8 * HTB, NXCD = 8, WGM = 8;

__host__ __device__ __forceinline__ int lds_byte(int r, int c) { const int st = (r >> 4) * 2 + (c >> 5), rr = r & 15, cc = c & 31, ob = rr * 64 + cc * 2; return st * 1024 + (ob ^ (((ob >> 9) & 1) << 5)); }
__host__ __device__ __forceinline__ void stage_rc(int b, int& R, int& C) { const int st = b / 1024, sb = b % 1024, swz = sb ^ (((sb >> 9) & 1) << 5); R = (st >> 1) * 16 + swz / 64; C = (st & 1) * 32 + (swz % 64) / 2; }
__host__ __device__ __forceinline__ int perm32(int rho) { const int n = rho >> 4, i = rho & 15; return 8 * (i >> 2) + 4 * n + (i & 3); }

struct Unit { int pm, pn; };
struct Gemm { const bf16_t* A; const bf16_t* Bt; int M, N, K; };

struct StaticOrder {
    int nM, nN, nwg, G, c;
    __host__ __device__ void init(int M, int N, int G_, int c_) { nM = M / BM; nN = N / BM; nwg = nM * nN; G = G_; c = c_; }
    __host__ __device__ bool next(int i, Unit& u) const {
        const long L = (long)i * G + c; if (L >= nwg) return false;
        int wgid = (int)L; { const int q = nwg / NXCD, r = nwg % NXCD, xcd = wgid % NXCD, off = wgid / NXCD; wgid = (xcd < r ? xcd * (q + 1) : r * (q + 1) + (xcd - r) * q) + off; }
        const int nig = WGM * nN, gid = wgid / nig, fm = gid * WGM, gsz = (nM - fm) < WGM ? (nM - fm) : WGM;
        u.pm = fm + ((wgid % nig) % gsz); u.pn = (wgid % nig) / gsz; return true;
    }
    __device__ __forceinline__ void a_ready(const Unit&) const {}
    __device__ __forceinline__ void done(const Unit&) const {}
};

__device__ __forceinline__ u32x4 pack8(f32x4 v0, f32x4 v1) { u32x4 w; w.x = cvtpk(v0[0], v0[1]); w.y = cvtpk(v0[2], v0[3]); w.z = cvtpk(v1[0], v1[1]); w.w = cvtpk(v1[2], v1[3]); return w; }

struct EpiInProj {
    static constexpr bool PERM = true, AFTER_DRAIN = false;
    bf16_t *Q, *U; size_t tstride;
    __device__ __forceinline__ void operator()(const f32x4 (&acc)[2][2][4][2], const Unit& u, int wr, int wc, int fr, int fq) const {
        const int row0 = u.pm * BM + wr * 64 + fr;
        if (u.pn < 6) {
            const int t = u.pn >> 1; bf16_t* base = Q + (size_t)t * tstride; const float sc = (t == 0) ? QSCALE : 1.0f;
            const int col0 = (u.pn & 1) * 256 + wc * 32 + 8 * fq;
#pragma unroll
            for (int ai = 0; ai < 2; ++ai)
#pragma unroll
                for (int m = 0; m < 4; ++m) { bf16_t* rowp = base + (size_t)(row0 + ai * HALF + m * 16) * DA + col0;
#pragma unroll
                    for (int bj = 0; bj < 2; ++bj) *(u32x4*)(rowp + bj * HALF) = pack8(acc[ai][bj][m][0] * sc, acc[ai][bj][m][1] * sc); }
        } else {
            const int col0 = (u.pn - 6) * 128 + wc * 32 + 8 * fq;
#pragma unroll
            for (int ai = 0; ai < 2; ++ai)
#pragma unroll
                for (int m = 0; m < 4; ++m) { bf16_t* rowp = U + (size_t)(row0 + ai * HALF + m * 16) * DC + col0; f32x4 o[2];
#pragma unroll
                    for (int n = 0; n < 2; ++n) { const f32x4 a = acc[ai][0][m][n], g = acc[ai][1][m][n];
#pragma unroll
                        for (int e = 0; e < 4; ++e) o[n][e] = a[e] * __builtin_amdgcn_rcpf(1.0f + __builtin_amdgcn_exp2f(-LOG2E * g[e])); }
                    *(u32x4*)rowp = pack8(o[0], o[1]); }
        }
    }
};
struct EpiOutProj {
    static constexpr bool PERM = true, AFTER_DRAIN = false;
    const float* xin; float* X1; bf16_t* X1B; float* ssq;
    __device__ __forceinline__ void operator()(const f32x4 (&acc)[2][2][4][2], const Unit& u, int wr, int wc, int fr, int fq) const {
        const int row0 = u.pm * BM + wr * 64 + fr, col0 = u.pn * BM + wc * 32 + 8 * fq;
#pragma unroll
        for (int ai = 0; ai < 2; ++ai)
#pragma unroll
            for (int m = 0; m < 4; ++m) { const int row = row0 + ai * HALF + m * 16; float s = 0.f;
#pragma unroll
                for (int bj = 0; bj < 2; ++bj) { const size_t off = (size_t)row * DM + col0 + bj * HALF;
                    const f32x4 v0 = acc[ai][bj][m][0] + *(const f32x4*)(xin + off), v1 = acc[ai][bj][m][1] + *(const f32x4*)(xin + off + 4);
                    *(f32x4*)(X1 + off) = v0; *(f32x4*)(X1 + off + 4) = v1; *(u32x4*)(X1B + off) = pack8(v0, v1);
                    s += (v0[0] * v0[0] + v0[1] * v0[1]) + (v0[2] * v0[2] + v0[3] * v0[3]) + (v1[0] * v1[0] + v1[1] * v1[1]) + (v1[2] * v1[2] + v1[3] * v1[3]); }
                s += __shfl_xor(s, 16); s += __shfl_xor(s, 32);
                if (fq == 0) ssq[(size_t)row * 16 + u.pn * 4 + wc] = s;
                if (m & 1) asm volatile("" ::: "memory"); }
    }
};
struct EpiFF1 {
    static constexpr bool PERM = true, AFTER_DRAIN = false;
    bf16_t* F; const float* ssq;
    __device__ __forceinline__ void operator()(const f32x4 (&acc)[2][2][4][2], const Unit& u, int wr, int wc, int fr, int fq) const {
        const int row0 = u.pm * BM + wr * 64 + fr, col0 = u.pn * BM + wc * 32 + 8 * fq;
#pragma unroll
        for (int ai = 0; ai < 2; ++ai)
#pragma unroll
            for (int m = 0; m < 4; ++m) { const int row = row0 + ai * HALF + m * 16; const f32x4* sp = (const f32x4*)(ssq + (size_t)row * 16);
                const f32x4 s0 = sp[0], s1 = sp[1], s2 = sp[2], s3 = sp[3];
                const float ss = ((s0[0] + s0[1]) + (s0[2] + s0[3])) + ((s1[0] + s1[1]) + (s1[2] + s1[3])) + ((s2[0] + s2[1]) + (s2[2] + s2[3])) + ((s3[0] + s3[1]) + (s3[2] + s3[3]));
                const float r2 = 1.0f / (ss * (1.0f / DM) + RMS_EPS);
                bf16_t* rowp = F + (size_t)row * FF + col0;
#pragma unroll
                for (int bj = 0; bj < 2; ++bj) { f32x4 v0 = acc[ai][bj][m][0], v1 = acc[ai][bj][m][1];
#pragma unroll
                    for (int e = 0; e < 4; ++e) { const float a = fmaxf(v0[e], 0.f), b = fmaxf(v1[e], 0.f); v0[e] = a * a * r2; v1[e] = b * b * r2; }
                    *(u32x4*)(rowp + bj * HALF) = pack8(v0, v1); } }
    }
};
struct EpiFF2 {
    static constexpr bool PERM = true, AFTER_DRAIN = false;
    const float* X1; float* out;
    __device__ __forceinline__ void operator()(const f32x4 (&acc)[2][2][4][2], const Unit& u, int wr, int wc, int fr, int fq) const {
        const int row0 = u.pm * BM + wr * 64 + fr, col0 = u.pn * BM + wc * 32 + 8 * fq;
#pragma unroll
        for (int ai = 0; ai < 2; ++ai)
#pragma unroll
            for (int m = 0; m < 4; ++m) { const int row = row0 + ai * HALF + m * 16;
#pragma unroll
                for (int bj = 0; bj < 2; ++bj) { const size_t off = (size_t)row * DM + col0 + bj * HALF;
                    *(f32x4*)(out + off) = acc[ai][bj][m][0] + *(const f32x4*)(X1 + off); *(f32x4*)(out + off + 4) = acc[ai][bj][m][1] + *(const f32x4*)(X1 + off + 4); }
                if (m & 1) asm volatile("" ::: "memory"); }
    }
};
template <class Epi, class Sched, bool ALIGN_EPI = false, bool SP2 = false>
__device__ __forceinline__ void gemm_phase(PG8_LAS unsigned char* lds, const Gemm g, const Sched& S, const Epi& E) {
    const int tid = threadIdx.x, wid = __builtin_amdgcn_readfirstlane(tid >> 6), lane = tid & 63, wr = wid >> 2, wc = wid & 3, fr = lane & 15, fq = lane >> 4;
    const int K = g.K, nt = K / BK;
    unsigned voffA[2], voffB[2];
#pragma unroll
    for (int i = 0; i < 2; ++i) { int R, C; stage_rc(tid * 16 + i * 8192, R, C); const int Rb = Epi::PERM ? ((R & ~31) + perm32(R & 31)) : R;
        voffA[i] = (unsigned)(R * K + C) * 2u; voffB[i] = (unsigned)(Rb * K + C) * 2u; }
    const size_t kstep = (size_t)(BK * 2);
    const size_t hstep = (size_t)HALF * K * 2;
    const size_t tstep = 2 * hstep;
    const unsigned ldsw = (unsigned)wid * 1024u;
    const int aoff = lds_byte(wr * 64 + fr, fq * 8), boff = lds_byte(wc * 32 + fr, fq * 8);
#define PG8_SA(b, h) (((b) * 2 + (h)) * HTB)
#define PG8_SB(b, h) ((4 + (b) * 2 + (h)) * HTB)
#define PG8_STAGE(bufoff, gbase, voff) do { _Pragma("unroll") for (int _i = 0; _i < 2; ++_i) \
        __builtin_amdgcn_global_load_lds((const unsigned*)((const char*)(gbase) + (voff)[_i]), (PG8_LAS unsigned*)(lds + (bufoff) + ldsw + _i * 8192), 16, 0, 0); } while (0)
#define PG8_LDA(dst, b, h) do { _Pragma("unroll") for (int m = 0; m < 4; ++m) _Pragma("unroll") for (int k = 0; k < 2; ++k) dst[m][k] = *(const PG8_LAS bf16x8*)(lds + PG8_SA(b, h) + aoff + m * 2048 + k * 1024); } while (0)
#define PG8_LDB(dst, b, h) do { _Pragma("unroll") for (int n = 0; n < 2; ++n) _Pragma("unroll") for (int k = 0; k < 2; ++k) dst[n][k] = *(const PG8_LAS bf16x8*)(lds + PG8_SB(b, h) + boff + n * 2048 + k * 1024); } while (0)
#define PG8_MMA(ai, bj, At, Bt) do { __builtin_amdgcn_s_setprio(1); _Pragma("unroll") for (int m = 0; m < 4; ++m) _Pragma("unroll") for (int n = 0; n < 2; ++n) _Pragma("unroll") for (int k = 0; k < 2; ++k) \
        acc[ai][bj][m][n] = __builtin_amdgcn_mfma_f32_16x16x32_bf16(Bt[n][k], At[m][k], acc[ai][bj][m][n], 0, 0, 0); __builtin_amdgcn_s_setprio(0); } while (0)
#define PG8_WAIT_V(n) asm volatile("s_waitcnt vmcnt(" #n ")" ::: "memory")
#define PG8_WAIT_L(n) asm volatile("s_waitcnt lgkmcnt(" #n ")" ::: "memory")
#define PG8_BAR __builtin_amdgcn_s_barrier()
#define PG8_SCHED __builtin_amdgcn_sched_barrier(0)
    Unit cur, nxt; int ui = 0;
    if (!S.next(0, cur)) return;
    f32x4 acc[2][2][4][2];
#pragma unroll
    for (int a = 0; a < 2; ++a)
#pragma unroll
        for (int b = 0; b < 2; ++b)
#pragma unroll
            for (int m = 0; m < 4; ++m)
#pragma unroll
                for (int n = 0; n < 2; ++n) acc[a][b][m][n] = (f32x4){0.f, 0.f, 0.f, 0.f};
    bf16x8 At[4][2], B0[2][2], B1[2][2];
    const char* cA = (const char*)g.A + (size_t)cur.pm * tstep; const char* cB = (const char*)g.Bt + (size_t)cur.pn * tstep;
    S.a_ready(cur);
    if constexpr (SP2) {
        PG8_STAGE(PG8_SB(0, 0), cB, voffB); PG8_STAGE(PG8_SB(0, 1), cB + hstep, voffB); PG8_STAGE(PG8_SA(0, 0), cA, voffA); PG8_STAGE(PG8_SA(0, 1), cA + hstep, voffA);
        if (wr == 1) PG8_BAR;
        PG8_WAIT_V(2); PG8_BAR;
        PG8_STAGE(PG8_SB(1, 0), cB + kstep, voffB); PG8_STAGE(PG8_SA(1, 0), cA + kstep, voffA); PG8_STAGE(PG8_SB(1, 1), cB + hstep + kstep, voffB);
        PG8_WAIT_V(6); PG8_BAR;
    } else {
        PG8_STAGE(PG8_SB(0, 0), cB, voffB); PG8_STAGE(PG8_SA(0, 0), cA, voffA); PG8_STAGE(PG8_SB(0, 1), cB + hstep, voffB); PG8_STAGE(PG8_SA(0, 1), cA + hstep, voffA);
        if (wr == 1) PG8_BAR;
        PG8_WAIT_V(4); PG8_BAR;
        PG8_STAGE(PG8_SB(1, 0), cB + kstep, voffB); PG8_STAGE(PG8_SA(1, 0), cA + kstep, voffA); PG8_STAGE(PG8_SB(1, 1), cB + hstep + kstep, voffB);
        PG8_WAIT_V(6); PG8_BAR;
    }
    for (;;) {
        const bool has_next = S.next(ui + 1, nxt);
        const char* nA = has_next ? (const char*)g.A + (size_t)nxt.pm * tstep : cA; const char* nB = has_next ? (const char*)g.Bt + (size_t)nxt.pn * tstep : cB;
        for (int t = 0; t < nt; t += 2) {
            const bool last = (t == nt - 2);
            const char* a1 = cA + (size_t)(t + 1) * kstep;
            const char* a2 = last ? nA : cA + (size_t)(t + 2) * kstep; const char* b2 = last ? nB : cB + (size_t)(t + 2) * kstep;
            const char* a3 = a2 + kstep; const char* b3 = b2 + kstep;
            if (last && has_next) S.a_ready(nxt);
            if constexpr (SP2) {
            PG8_LDB(B0, 0, 0); PG8_LDB(B1, 0, 1); PG8_SCHED; PG8_LDA(At, 0, 0); PG8_STAGE(PG8_SA(1, 1), a1 + hstep, voffA);
            PG8_WAIT_V(8); PG8_WAIT_L(0); PG8_BAR; PG8_MMA(0, 0, At, B0); PG8_MMA(0, 1, At, B1); PG8_BAR; PG8_SCHED;
            PG8_LDA(At, 0, 1); PG8_STAGE(PG8_SB(0, 0), b2, voffB); PG8_STAGE(PG8_SB(0, 1), b2 + hstep, voffB); PG8_STAGE(PG8_SA(0, 0), a2, voffA);
            PG8_WAIT_V(8); PG8_WAIT_L(0); PG8_BAR; PG8_MMA(1, 0, At, B0); PG8_MMA(1, 1, At, B1); PG8_BAR; PG8_SCHED;
            PG8_LDB(B0, 1, 0); PG8_LDB(B1, 1, 1); PG8_SCHED; PG8_LDA(At, 1, 0); PG8_STAGE(PG8_SA(0, 1), a2 + hstep, voffA);
            PG8_WAIT_V(8); PG8_WAIT_L(0); PG8_BAR; PG8_MMA(0, 0, At, B0); PG8_MMA(0, 1, At, B1); PG8_BAR; PG8_SCHED;
            PG8_LDA(At, 1, 1); PG8_STAGE(PG8_SB(1, 0), b3, voffB); PG8_STAGE(PG8_SB(1, 1), b3 + hstep, voffB); PG8_STAGE(PG8_SA(1, 0), a3, voffA);
            PG8_WAIT_V(8); PG8_WAIT_L(0); PG8_BAR; PG8_MMA(1, 0, At, B0); PG8_MMA(1, 1, At, B1); PG8_BAR; PG8_SCHED;
            } else {
            PG8_LDB(B0, 0, 0); PG8_SCHED; PG8_LDA(At, 0, 0); PG8_STAGE(PG8_SA(1, 1), a1 + hstep, voffA);
            PG8_WAIT_L(8); PG8_BAR; PG8_WAIT_L(0); PG8_MMA(0, 0, At, B0); PG8_BAR; PG8_SCHED;
            PG8_LDB(B1, 0, 1); PG8_STAGE(PG8_SB(0, 0), b2, voffB);
            PG8_BAR; PG8_WAIT_L(0); PG8_MMA(0, 1, At, B1); PG8_BAR;
            PG8_LDA(At, 0, 1); PG8_STAGE(PG8_SA(0, 0), a2, voffA);
            PG8_BAR; PG8_WAIT_L(0); PG8_MMA(1, 0, At, B0); PG8_BAR; PG8_SCHED;
            PG8_STAGE(PG8_SB(0, 1), b2 + hstep, voffB);
            PG8_WAIT_V(6); PG8_BAR; PG8_MMA(1, 1, At, B1); PG8_BAR;
            PG8_LDB(B0, 1, 0); PG8_SCHED; PG8_LDA(At, 1, 0); PG8_STAGE(PG8_SA(0, 1), a2 + hstep, voffA);
            PG8_WAIT_L(8); PG8_BAR; PG8_WAIT_L(0); PG8_MMA(0, 0, At, B0); PG8_BAR; PG8_SCHED;
            PG8_LDB(B1, 1, 1); PG8_STAGE(PG8_SB(1, 0), b3, voffB);
            PG8_BAR; PG8_WAIT_L(0); PG8_MMA(0, 1, At, B1); PG8_BAR;
            PG8_LDA(At, 1, 1); PG8_STAGE(PG8_SA(1, 0), a3, voffA);
            PG8_BAR; PG8_WAIT_L(0); PG8_MMA(1, 0, At, B0); PG8_BAR; PG8_SCHED;
            PG8_STAGE(PG8_SB(1, 1), b3 + hstep, voffB);
            PG8_WAIT_V(6); PG8_BAR; PG8_MMA(1, 1, At, B1); PG8_BAR;
            }
        }
        if constexpr (ALIGN_EPI) { if (wr == 0) PG8_BAR; }
        if constexpr (!Epi::AFTER_DRAIN) { E(acc, cur, wr, wc, fr, fq); S.done(cur); }
        if (!has_next) break;
#pragma unroll
        for (int a = 0; a < 2; ++a)
#pragma unroll
            for (int b = 0; b < 2; ++b)
#pragma unroll
                for (int m = 0; m < 4; ++m)
#pragma unroll
                    for (int n = 0; n < 2; ++n) acc[a][b][m][n] = (f32x4){0.f, 0.f, 0.f, 0.f};
        cur = nxt; cA = nA; cB = nB; ++ui;
        if constexpr (ALIGN_EPI) { if (wr == 1) PG8_BAR; }
    }
    PG8_WAIT_V(0);
    if constexpr (!ALIGN_EPI) { if (wr == 0) PG8_BAR; }
    PG8_BAR;
    if constexpr (Epi::AFTER_DRAIN) { E.fused(acc, cur, wr, wc, fr, fq, lds, wid, lane); S.done(cur); }
#undef PG8_SA
#undef PG8_SB
#undef PG8_STAGE
#undef PG8_LDA
#undef PG8_LDB
#undef PG8_MMA
#undef PG8_WAIT_V
#undef PG8_WAIT_L
#undef PG8_BAR
#undef PG8_SCHED
}
}

namespace att {
constexpr int TOKB = 512, ST_PITCH = 144;
constexpr int L_ST = 0, L_M = TOKB * ST_PITCH, L_L = L_M + TOKB * 4, L_TB = L_L + TOKB * 4, TB_BYTES = 4 * 192 * 4, L_KV = L_TB + 3 * TB_BYTES, KV_WAVE = 8192, LDS_BYTES = L_KV + 8 * KV_WAVE;
constexpr float NEG = -1e30f;
__device__ __forceinline__ int t5_bucket(int n) {
    if (n < 16) return n;
    int b = 16;
    b += (n >= 22); b += (n >= 30); b += (n >= 40); b += (n >= 54); b += (n >= 73); b += (n >= 99); b += (n >= 134); b += (n >= 182);
    b += (n >= 246); b += (n >= 332); b += (n >= 450); b += (n >= 609); b += (n >= 825); b += (n >= 1117); b += (n >= 1513);
    return b;
}
__device__ __forceinline__ s16x4 vtr(const LAS unsigned char* p) { return __builtin_bit_cast(s16x4, __builtin_amdgcn_ds_read_tr16_b64_v4i16((LAS s16x4*)p)); }

struct Ctx {
    const bf16_t *Q, *K, *V;
    LAS unsigned char* lds;
    size_t rowbase;
    int h, tok0;
    int lane, ql, hi, wid;
};

template <int NQ, bool FIRST, bool LAST>
__device__ __forceinline__ void wave_unit(const Ctx& c, const int d, const int r, const int p0, const LAS unsigned char* tbl) {
    const int lane = c.lane, ql = c.ql, hi = c.hi;
    LAS unsigned char* kl = c.lds + L_KV + c.wid * KV_WAVE; LAS unsigned char* vl = kl + 4096;
    LAS unsigned char* st = c.lds + L_ST; LAS float* stM = (LAS float*)(c.lds + L_M); LAS float* stL = (LAS float*)(c.lds + L_L);
    bf16x8 qf[NQ][4]; f32x16 o[NQ][2]; float m[NQ], l[NQ]; int lt[NQ];
#pragma unroll
    for (int qi = 0; qi < NQ; ++qi) {
        const int tok = d * (p0 + 32 * qi + ql) + r; lt[qi] = tok - c.tok0;
        const bf16_t* qp = c.Q + (c.rowbase + tok) * DA + c.h * HD + hi * 8;
#pragma unroll
        for (int d0 = 0; d0 < 4; ++d0) qf[qi][d0] = *(const bf16x8*)(qp + d0 * 16);
        if (FIRST) { m[qi] = NEG; l[qi] = 0.f;
#pragma unroll
            for (int bk = 0; bk < 2; ++bk)
#pragma unroll
                for (int e = 0; e < 16; ++e) o[qi][bk][e] = 0.f;
        } else {
            m[qi] = stM[lt[qi]]; l[qi] = hi ? 0.f : stL[lt[qi]];
#pragma unroll
            for (int bk = 0; bk < 2; ++bk)
#pragma unroll
                for (int g = 0; g < 4; ++g) { const u32x2 w = *(const LAS u32x2*)(st + lt[qi] * ST_PITCH + (32 * bk + 8 * g + 4 * hi) * 2);
                    o[qi][bk][4 * g + 0] = __builtin_bit_cast(float, w.x << 16); o[qi][bk][4 * g + 1] = __builtin_bit_cast(float, w.x & 0xffff0000u);
                    o[qi][bk][4 * g + 2] = __builtin_bit_cast(float, w.y << 16); o[qi][bk][4 * g + 3] = __builtin_bit_cast(float, w.y & 0xffff0000u); }
        }
    }
    const int kc = (3 - ql) & 3; const LAS unsigned char* tb = tbl + kc * 768 + (159 - ql + 4 * hi - kc) * 4;
    const int ch = lane & 7, kr = lane >> 3;
    const bf16_t* kbase = c.K + c.rowbase * DA + c.h * HD + ch * 8; const bf16_t* vbase = c.V + c.rowbase * DA + c.h * HD + ch * 8;
    const int vb = ((lane >> 4) & 1) * 32 + (lane & 3) * 8 + (4 * hi + ((lane & 15) >> 2)) * 64;
    constexpr int NKT = 4 + NQ;
    int kt = 0; while (p0 - 128 + 32 * kt < 0) ++kt;
    u32x4 kreg[4], vreg[4];
#define ATT_ISSUE(KT) do { const int k0_ = p0 - 128 + 32 * (KT); _Pragma("unroll") for (int i = 0; i < 4; ++i) { const size_t ro = (size_t)(d * (k0_ + kr + 8 * i) + r) * DA; \
        kreg[i] = *(const u32x4*)(kbase + ro); vreg[i] = *(const u32x4*)(vbase + ro); } } while (0)
    ATT_ISSUE(kt);
    for (; kt < NKT; ++kt) {
        const int k0 = p0 - 128 + 32 * kt;
#pragma unroll
        for (int i = 0; i < 4; ++i) { const int key = kr + 8 * i;
            *(LAS u32x4*)(kl + ch * 512 + ((key ^ ch) & 31) * 16) = kreg[i];
            *(LAS u32x4*)(vl + (ch >> 2) * 2048 + (key >> 3) * 512 + (key & 7) * 64 + (ch & 3) * 16) = vreg[i]; }
        if (kt + 1 < NKT) ATT_ISSUE(kt + 1);
#pragma unroll
        for (int qi = 0; qi < NQ; ++qi) {
            const int dl = p0 + 32 * qi - k0;
            if (dl < 0 || dl > 128) continue;
            f32x16 s;
#pragma unroll
            for (int g = 0; g < 4; ++g) { const f32x4 t = *(const LAS f32x4*)(tb + (8 * g - dl) * 4); s[4 * g] = t[0]; s[4 * g + 1] = t[1]; s[4 * g + 2] = t[2]; s[4 * g + 3] = t[3]; }
#pragma unroll
            for (int d0 = 0; d0 < 4; ++d0) { const int cc = 2 * d0 + hi; const bf16x8 kf = *(const LAS bf16x8*)(kl + cc * 512 + ((ql ^ cc) & 31) * 16);
                s = __builtin_amdgcn_mfma_f32_32x32x16_bf16(kf, qf[qi][d0], s, 0, 0, 0); }
            float rm = fmaxf(fmaxf(s[0], s[1]), fmaxf(s[2], s[3]));
#pragma unroll
            for (int e = 4; e < 16; e += 4) rm = fmaxf(rm, fmaxf(fmaxf(s[e], s[e + 1]), fmaxf(s[e + 2], s[e + 3])));
            rm = fmaxf(rm, __shfl_xor(rm, 32));
            const float mn = fmaxf(m[qi], rm), alpha = __builtin_amdgcn_exp2f(m[qi] - mn); m[qi] = mn;
            float ps = 0.f;
#pragma unroll
            for (int e = 0; e < 16; ++e) { s[e] = __builtin_amdgcn_exp2f(s[e] - mn); ps += s[e]; }
            l[qi] = l[qi] * alpha + ps;
#pragma unroll
            for (int bk = 0; bk < 2; ++bk)
#pragma unroll
                for (int e = 0; e < 16; ++e) o[qi][bk][e] *= alpha;
            u32x4 pw[2];
#pragma unroll
            for (int s2 = 0; s2 < 2; ++s2) { pw[s2].x = cvtpk(s[8 * s2], s[8 * s2 + 1]); pw[s2].y = cvtpk(s[8 * s2 + 2], s[8 * s2 + 3]); pw[s2].z = cvtpk(s[8 * s2 + 4], s[8 * s2 + 5]); pw[s2].w = cvtpk(s[8 * s2 + 6], s[8 * s2 + 7]); }
#pragma unroll
            for (int bk = 0; bk < 2; ++bk)
#pragma unroll
                for (int s2 = 0; s2 < 2; ++s2) { const s16x4 lo = vtr(vl + vb + bk * 2048 + s2 * 1024), hh = vtr(vl + vb + bk * 2048 + s2 * 1024 + 512);
                    const bf16x8 vf = (bf16x8){lo[0], lo[1], lo[2], lo[3], hh[0], hh[1], hh[2], hh[3]};
                    o[qi][bk] = __builtin_amdgcn_mfma_f32_32x32x16_bf16(vf, __builtin_bit_cast(bf16x8, pw[s2]), o[qi][bk], 0, 0, 0); }
        }
    }
#undef ATT_ISSUE
#pragma unroll
    for (int qi = 0; qi < NQ; ++qi) {
        const float lt_ = l[qi] + __shfl_xor(l[qi], 32); const float sc = LAST ? (1.0f / lt_) : 1.0f;
#pragma unroll
        for (int bk = 0; bk < 2; ++bk)
#pragma unroll
            for (int g = 0; g < 4; ++g) { u32x2 w; w.x = cvtpk(o[qi][bk][4 * g] * sc, o[qi][bk][4 * g + 1] * sc); w.y = cvtpk(o[qi][bk][4 * g + 2] * sc, o[qi][bk][4 * g + 3] * sc);
                *(LAS u32x2*)(st + lt[qi] * ST_PITCH + (32 * bk + 8 * g + 4 * hi) * 2) = w; }
        if (!LAST && hi == 0) { stM[lt[qi]] = m[qi]; stL[lt[qi]] = lt_; }
    }
}

__device__ __forceinline__ void attn_unit(int b, int h, int blk, const bf16_t* Q, const bf16_t* K, const bf16_t* V, bf16_t* MIX, const float* relb, LAS unsigned char* lds) {
    const int tid = threadIdx.x;
    Ctx c; c.Q = Q; c.K = K; c.V = V; c.lds = lds; c.rowbase = (size_t)b * SEQ; c.h = h; c.tok0 = blk * TOKB;
    c.lane = tid & 63; c.ql = c.lane & 31; c.hi = c.lane >> 5; c.wid = __builtin_amdgcn_readfirstlane(tid >> 6);
    LAS float* tbw = (LAS float*)(lds + L_TB);
    for (int t = tid; t < 3 * 768; t += 512) { const int br = t / 768, rem = t % 768, k = rem / 192, j = rem % 192, dist = 159 - (j + k), dd = (br == 0) ? 16 : ((br == 1) ? 4 : 1);
        float v = NEG; if (dist >= 0 && dist <= 128) v = relb[t5_bucket(dist * dd) * NH + h] * LOG2E;
        tbw[t] = v; }
    __syncthreads();
    const LAS unsigned char* tb0 = lds + L_TB;
    const int w = c.wid;
    wave_unit<1, true, false>(c, 16, w, 32 * blk, tb0);
    wave_unit<1, true, false>(c, 16, w + 8, 32 * blk, tb0);
    __syncthreads();
    wave_unit<2, false, false>(c, 4, w & 3, 128 * blk + 64 * (w >> 2), tb0 + TB_BYTES);
    __syncthreads();
    wave_unit<2, false, true>(c, 1, 0, 512 * blk + 64 * w, tb0 + 2 * TB_BYTES);
    __syncthreads();
    bf16_t* dst = MIX + (c.rowbase + c.tok0) * DM + h * HD;
#pragma unroll
    for (int i = 0; i < 8; ++i) { const int idx = tid + 512 * i, row = idx >> 3, chn = idx & 7;
        const u32x4 v = *(const LAS u32x4*)(lds + L_ST + row * ST_PITCH + chn * 16); *(u32x4*)(dst + (size_t)row * DM + chn * 8) = v; }
    __syncthreads();
}
}

namespace cv {
constexpr int TT = 32;
__device__ __forceinline__ void conv_unit(int b, int tb, const bf16_t* U, bf16_t* MIX, const float* cw, const float* cb, const float* lg, const float* lb, LAS unsigned char* lds) {
    const int tid = threadIdx.x, lane = tid & 63, wid = tid >> 6; const int t0 = tb * TT; const size_t rowbase = (size_t)b * SEQ;
    LAS float* y = (LAS float*)lds;
    {
        const int ch = tid; float wgt[CW];
#pragma unroll
        for (int k = 0; k < CW; ++k) wgt[k] = cw[k * DC + ch];
        float win[TT + CW - 1];
#pragma unroll
        for (int i = 0; i < TT + CW - 1; ++i) { const int t = t0 - (CW - 1) + i; win[i] = (t >= 0) ? bf2f(U[(rowbase + (t >= 0 ? t : 0)) * DC + ch]) : 0.f; }
        const float bias = cb[ch];
#pragma unroll
        for (int i = 0; i < TT; ++i) { float a = bias;
#pragma unroll
            for (int k = 0; k < CW; ++k) a += wgt[k] * win[i + k];
            y[i * DC + ch] = a; }
    }
    __syncthreads();
    const f32x4 g0 = *(const f32x4*)(lg + lane * 8), g1 = *(const f32x4*)(lg + lane * 8 + 4), b0 = *(const f32x4*)(lb + lane * 8), b1 = *(const f32x4*)(lb + lane * 8 + 4);
#pragma unroll
    for (int j = 0; j < 4; ++j) { const int tk = wid * 4 + j;
        f32x4 v0 = *(const LAS f32x4*)(y + tk * DC + lane * 8), v1 = *(const LAS f32x4*)(y + tk * DC + lane * 8 + 4);
        float s = ((v0[0] + v0[1]) + (v0[2] + v0[3])) + ((v1[0] + v1[1]) + (v1[2] + v1[3]));
#pragma unroll
        for (int o = 1; o < 64; o <<= 1) s += __shfl_xor(s, o);
        const float mu = s * (1.0f / DC); v0 = v0 - mu; v1 = v1 - mu;
        float q = ((v0[0] * v0[0] + v0[1] * v0[1]) + (v0[2] * v0[2] + v0[3] * v0[3])) + ((v1[0] * v1[0] + v1[1] * v1[1]) + (v1[2] * v1[2] + v1[3] * v1[3]));
#pragma unroll
        for (int o = 1; o < 64; o <<= 1) q += __shfl_xor(q, o);
        const float rs = 1.0f / sqrtf(q * (1.0f / DC) + LN_EPS);
        v0 = v0 * rs * g0 + b0; v1 = v1 * rs * g1 + b1;
#pragma unroll
        for (int e = 0; e < 4; ++e) { v0[e] = v0[e] * __builtin_amdgcn_rcpf(1.0f + __builtin_amdgcn_exp2f(-LOG2E * v0[e])); v1[e] = v1[e] * __builtin_amdgcn_rcpf(1.0f + __builtin_amdgcn_exp2f(-LOG2E * v1[e])); }
        u32x4 wv; wv.x = cvtpk(v0[0], v0[1]); wv.y = cvtpk(v0[2], v0[3]); wv.z = cvtpk(v1[0], v1[1]); wv.w = cvtpk(v1[2], v1[3]);
        *(u32x4*)(MIX + (rowbase + t0 + tk) * DM + DA + lane * 8) = wv; }
    __syncthreads();
}
}

constexpr size_t MiB = 1u << 20;
constexpr size_t WS_CTL = 0, CTL_ZERO_BYTES = 1 * MiB;
constexpr size_t WS_SSQ = 1 * MiB;
constexpr size_t WS_WIN = 8 * MiB, WS_WO = 13 * MiB, WS_W1 = 16 * MiB, WS_W2 = 24 * MiB;
constexpr size_t WS_XB = 32 * MiB;
constexpr size_t WS_Q = 96 * MiB, WS_K = 128 * MiB, WS_V = 160 * MiB, WS_U = 192 * MiB;
constexpr size_t WS_MIX = 224 * MiB;
constexpr size_t WS_F = 32 * MiB;
constexpr size_t WS_X1 = 288 * MiB, WS_X1B = 416 * MiB, WS_END = 480 * MiB;
constexpr int CW_BAR = 4096;

constexpr int LDS_BYTES = 163840;
constexpr int MISC_OFF = LDS_BYTES - 256;
static_assert(att::LDS_BYTES <= MISC_OFF && pg8::STAGE_BYTES <= MISC_OFF, "LDS map");

typedef GAS unsigned gu32;
#define RLX_AGENT __ATOMIC_RELAXED, __HIP_MEMORY_SCOPE_AGENT
#define LDS_WAIT() asm volatile("s_waitcnt lgkmcnt(0)" ::: "memory")
#define VM_WAIT() asm volatile("s_waitcnt vmcnt(0)" ::: "memory")
#define XB_TMO      128
#define XB_XCNT(j)  (256  + 64 * (j))
#define XB_XSUB(j)  (1280 + 64 * (j))
#define XB_XGEN(j)  (2304 + 64 * (j))
#define XB_TOP      3328
#define XB_TOPGEN   3392
#define XCD_BAR_WORDS 3456
#define XB_SPIN_CAP (1u << 18)

__device__ __forceinline__ unsigned xb_ld(unsigned* p)              { return __hip_atomic_load(p, __ATOMIC_RELAXED, __HIP_MEMORY_SCOPE_AGENT); }
__device__ __forceinline__ unsigned xb_add(unsigned* p, unsigned v) { return __hip_atomic_fetch_add(p, v, __ATOMIC_RELAXED, __HIP_MEMORY_SCOPE_AGENT); }
__device__ __forceinline__ unsigned xb_xcc_id() { return (unsigned)__builtin_amdgcn_s_getreg((3 << 11) | 20) & 0xFu; }
#define XB_SPIN(cond, bar) do { unsigned _sp = 0; while (cond) { __builtin_amdgcn_s_sleep(1); \
    if ((++_sp & 255u) == 0u) { if (xb_ld(&(bar)[XB_TMO])) break; if (_sp > XB_SPIN_CAP) { atomicAdd(&(bar)[XB_TMO], 1u); break; } } } } while (0)

struct XcdBarrier {
    unsigned* bar; unsigned x;
    volatile LAS unsigned* st;
};

__device__ __forceinline__ XcdBarrier xcd_barrier_post(unsigned* bar, volatile LAS unsigned* st) {
    XcdBarrier b; b.bar = bar; b.x = xb_xcc_id(); b.st = st;
    if (threadIdx.x == 0) (void)xb_add(&bar[XB_XCNT(b.x)], 1u);
    return b;
}
__device__ __forceinline__ void xcd_barrier_complete(unsigned* bar, unsigned x, unsigned& nloc, unsigned& nx) {
    const unsigned G = gridDim.x * gridDim.y * gridDim.z;
    unsigned sum, cnt, mine, sp = 0u;
    for (;;) {
        sum = 0u; cnt = 0u; mine = 0u;
#pragma unroll
        for (unsigned j = 0; j < 16; ++j) { const unsigned c = xb_ld(&bar[XB_XCNT(j)]); sum += c; cnt += (c > 0u) ? 1u : 0u; mine = (j == x) ? c : mine; }
        if (sum == G) break;
        __builtin_amdgcn_s_sleep(1);
        if ((++sp & 255u) == 0u) { if (xb_ld(&bar[XB_TMO])) break; if (sp > XB_SPIN_CAP) { atomicAdd(&bar[XB_TMO], 1u); break; } }
    }
    nloc = mine > 0u ? mine : 1u; nx = cnt > 0u ? cnt : 1u;
}

__device__ __forceinline__ void xcd_barrier(const XcdBarrier& b) {
    asm volatile("s_waitcnt vmcnt(0)" ::: "memory");
    __syncthreads();
    if (threadIdx.x == 0) {
        unsigned* bar = b.bar;
        __builtin_amdgcn_s_waitcnt(0);
        unsigned nloc = b.st[0], nx = b.st[1];
        if (nloc == 0u) { xcd_barrier_complete(bar, b.x, nloc, nx); b.st[0] = nloc; b.st[1] = nx; }
        const unsigned old = xb_add(&bar[XB_XSUB(b.x)], 1u);
        const unsigned gen = old / nloc;
        if (old + 1u == (gen + 1u) * nloc) {
            __builtin_amdgcn_fence(__ATOMIC_RELEASE, "agent");
            asm volatile("s_waitcnt vmcnt(0)" ::: "memory");
            const unsigned og = xb_add(&bar[XB_TOP], 1u);
            const unsigned tg = og / nx;
            if (og + 1u == (tg + 1u) * nx) xb_add(&bar[XB_TOPGEN], 1u);
            else XB_SPIN(xb_ld(&bar[XB_TOPGEN]) == tg, bar);
            __builtin_amdgcn_fence(__ATOMIC_ACQUIRE, "agent");
            xb_add(&bar[XB_XGEN(b.x)], 1u);
            asm volatile("s_waitcnt vmcnt(0)" ::: "memory");
        } else {
            XB_SPIN(xb_ld(&bar[XB_XGEN(b.x)]) == gen, bar);
            __builtin_amdgcn_fence(__ATOMIC_ACQUIRE, "agent");
            asm volatile("s_waitcnt vmcnt(0)" ::: "memory");
        }
    }
    __syncthreads();
}

__device__ __forceinline__ float wave_sum(float v) {
#pragma unroll
    for (int o = 1; o < 64; o <<= 1) v += __shfl_xor(v, o);
    return v;
}
__device__ __forceinline__ void p0_transpose_item(const float* W, int K, int N, bf16_t* WT, int k0, int n0, int out_row0, const float* gain, LAS float* scr, int lane) {
#pragma unroll 8
    for (int i = 0; i < 32; ++i) { const int kk = 2 * i + (lane >> 5); float v = W[(size_t)(k0 + kk) * N + n0 + (lane & 31)]; if (gain) v *= gain[k0 + kk]; scr[kk * 33 + (lane & 31)] = v; }
    LDS_WAIT(); asm volatile("" ::: "memory");
    const int c = lane & 7;
#pragma unroll
    for (int j = 0; j < 4; ++j) { const int n = (lane >> 3) + 8 * j; const LAS float* s = scr + (8 * c) * 33 + n;
        u32x4 o; o.x = cvtpk(s[0 * 33], s[1 * 33]); o.y = cvtpk(s[2 * 33], s[3 * 33]); o.z = cvtpk(s[4 * 33], s[5 * 33]); o.w = cvtpk(s[6 * 33], s[7 * 33]);
        *(u32x4*)(WT + (size_t)(out_row0 + n) * K + k0 + 8 * c) = o; }
    LDS_WAIT(); asm volatile("" ::: "memory");
}
__device__ __forceinline__ int inproj_row(int n) { if (n < 3 * DA) return n; const int v = n - 3 * DA; if (v < DC) return 3 * DA + 256 * (v >> 7) + (v & 127); const int g = v - DC; return 3 * DA + 256 * (g >> 7) + 128 + (g & 127); }

struct Args { const float* in[13]; float* out; unsigned char* ws; int ph_lo, ph_hi; };

__global__ void __launch_bounds__(512, 2) fwd_kernel(Args args) {
    extern __shared__ __attribute__((aligned(16))) unsigned char lds_raw[];
    LAS unsigned char* lds = (LAS unsigned char*)lds_raw;
    volatile LAS unsigned* MISC = (volatile LAS unsigned*)(lds + MISC_OFF);
    const int tid = threadIdx.x, lane = tid & 63, wave = __builtin_amdgcn_readfirstlane(tid >> 6);
    const int G = gridDim.x; const int bx = blockIdx.x; const int vcu = (G % 8 == 0) ? (bx % 8) * (G / 8) + bx / 8 : bx;
    unsigned char* ws = args.ws;
    const float* x = args.in[0]; const float* norm1_g = args.in[1]; const float* w_in = args.in[2]; const float* conv_w = args.in[3]; const float* conv_b = args.in[4];
    const float* ln_g = args.in[5]; const float* ln_b = args.in[6]; const float* w_o = args.in[7]; const float* norm2_g = args.in[8]; const float* w_ff1 = args.in[9];
    const float* w_ff2 = args.in[10]; const float* rel_bias = args.in[11]; const float* final_g = args.in[12];
    float* out = args.out;
    bf16_t* WIN_T = (bf16_t*)(ws + WS_WIN); bf16_t* WO_T = (bf16_t*)(ws + WS_WO); bf16_t* W1_T = (bf16_t*)(ws + WS_W1); bf16_t* W2_T = (bf16_t*)(ws + WS_W2);
    bf16_t* XB = (bf16_t*)(ws + WS_XB); bf16_t* QB = (bf16_t*)(ws + WS_Q); bf16_t* KB = (bf16_t*)(ws + WS_K); bf16_t* VB = (bf16_t*)(ws + WS_V); bf16_t* UB = (bf16_t*)(ws + WS_U);
    bf16_t* MIX = (bf16_t*)(ws + WS_MIX); bf16_t* FB = (bf16_t*)(ws + WS_F); float* X1 = (float*)(ws + WS_X1); bf16_t* X1B = (bf16_t*)(ws + WS_X1B); float* SSQ = (float*)(ws + WS_SSQ);
    gu32* ctl = (gu32*)(ws + WS_CTL);
    for (int u = tid; u < 64; u += 512) ((LAS unsigned*)(lds + MISC_OFF))[u] = 0u;
    __syncthreads();
    XcdBarrier bar; bar.bar = (unsigned*)(ctl + CW_BAR); bar.x = 0; bar.st = nullptr;
    if (N_LAUNCHES == 1) bar = xcd_barrier_post((unsigned*)(ctl + CW_BAR), MISC + 8);
    const int lo = args.ph_lo, hi = args.ph_hi;
#define IN(k) (lo <= (k) && (k) < hi)
#define SEAM(k) do { if (IN(k) && IN((k) + 1)) xcd_barrier(bar); } while (0)

    if (IN(0)) {
        LAS float* scr = (LAS float*)(lds + wave * 16384);
        const int gw = vcu * 8 + wave, NGW = G * 8;
        constexpr int I_IN = (DM / 64) * (NIN / 32), I_O = (DM / 64) * (DM / 32), I_1 = (DM / 64) * (FF / 32), I_2 = (FF / 64) * (DM / 32);
        for (int it = gw; it < I_IN + I_O + I_1 + I_2; it += NGW) {
            int r = it;
            if (r < I_IN) { const int nb = NIN / 32, kb = r / nb, n0 = 32 * (r % nb); p0_transpose_item(w_in, DM, NIN, WIN_T, 64 * kb, n0, inproj_row(n0), nullptr, scr, lane); continue; } r -= I_IN;
            if (r < I_O) { const int nb = DM / 32, kb = r / nb, n0 = 32 * (r % nb); p0_transpose_item(w_o, DM, DM, WO_T, 64 * kb, n0, n0, nullptr, scr, lane); continue; } r -= I_O;
            if (r < I_1) { const int nb = FF / 32, kb = r / nb, n0 = 32 * (r % nb); p0_transpose_item(w_ff1, DM, FF, W1_T, 64 * kb, n0, n0, norm2_g, scr, lane); continue; } r -= I_1;
            { const int nb = DM / 32, kb = r / nb, n0 = 32 * (r % nb); p0_transpose_item(w_ff2, FF, DM, W2_T, 64 * kb, n0, n0, nullptr, scr, lane); }
        }
        f32x4 gv[4];
#pragma unroll
        for (int j = 0; j < 4; ++j) gv[j] = *((const f32x4*)norm1_g + lane + 64 * j);
        for (int m = gw; m < M; m += NGW) {
            const f32x4* xr = (const f32x4*)(x + (size_t)m * DM) + lane; f32x4 v[4]; float s = 0.f;
#pragma unroll
            for (int j = 0; j < 4; ++j) { v[j] = xr[64 * j]; s += (v[j][0] * v[j][0] + v[j][1] * v[j][1]) + (v[j][2] * v[j][2] + v[j][3] * v[j][3]); }
            const float rs = 1.0f / sqrtf(wave_sum(s) * (1.0f / DM) + RMS_EPS);
            u32x2* o8 = (u32x2*)(XB + (size_t)m * DM) + lane;
#pragma unroll
            for (int j = 0; j < 4; ++j) { const f32x4 t = v[j] * rs * gv[j]; u32x2 w; w.x = cvtpk(t[0], t[1]); w.y = cvtpk(t[2], t[3]); o8[64 * j] = w; }
        }
    }
    SEAM(0);
    if (IN(1)) {
        pg8::Gemm g{XB, WIN_T, M, NIN, DM}; pg8::StaticOrder S; S.init(M, NIN, G, bx);
        pg8::EpiInProj E{QB, UB, (size_t)(WS_K - WS_Q) / 2};
        pg8::gemm_phase<pg8::EpiInProj, pg8::StaticOrder, true, true>(lds, g, S, E);
    }
    SEAM(1);
    if (IN(2)) {
        for (int i = 0; i < 2; ++i) { const int bh = vcu >> 1; const int blk = (vcu & 1) ? (1 + i) : (3 * i);
            if (bh < BATCH * NH) att::attn_unit(bh / NH, bh % NH, blk, QB, KB, VB, MIX, rel_bias, lds); }
        for (int cu = vcu; cu < BATCH * (SEQ / cv::TT); cu += G) cv::conv_unit(cu / (SEQ / cv::TT), cu % (SEQ / cv::TT), UB, MIX, conv_w, conv_b, ln_g, ln_b, lds);
    }
    SEAM(2);
    if (IN(3)) {
        pg8::Gemm g{MIX, WO_T, M, DM, DM}; pg8::StaticOrder S; S.init(M, DM, G, bx);
        pg8::EpiOutProj E{x, X1, X1B, SSQ};
        pg8::gemm_phase<pg8::EpiOutProj, pg8::StaticOrder, true, true>(lds, g, S, E);
    }
    SEAM(3);
    if (IN(4)) {
        pg8::Gemm g{X1B, W1_T, M, FF, DM}; pg8::StaticOrder S; S.init(M, FF, G, bx);
        pg8::EpiFF1 E{FB, SSQ};
        pg8::gemm_phase<pg8::EpiFF1, pg8::StaticOrder, true, true>(lds, g, S, E);
    }
    SEAM(4);
    if (IN(5)) {
        pg8::Gemm g{FB, W2_T, M, DM, FF}; pg8::StaticOrder S; S.init(M, DM, G, bx);
        pg8::EpiFF2 E{X1, out};
        pg8::gemm_phase<pg8::EpiFF2, pg8::StaticOrder, true, true>(lds, g, S, E);
    }
    SEAM(5);
    if (IN(6)) {
        const int gw = vcu * 8 + wave, NGW = G * 8;
        f32x4 gv[4];
#pragma unroll
        for (int j = 0; j < 4; ++j) gv[j] = *((const f32x4*)final_g + lane + 64 * j);
        for (int m = gw; m < M; m += NGW) {
            f32x4* xr = (f32x4*)(out + (size_t)m * DM) + lane; f32x4 v[4]; float s = 0.f;
#pragma unroll
            for (int j = 0; j < 4; ++j) { v[j] = xr[64 * j]; s += (v[j][0] * v[j][0] + v[j][1] * v[j][1]) + (v[j][2] * v[j][2] + v[j][3] * v[j][3]); }
            const float rs = 1.0f / sqrtf(wave_sum(s) * (1.0f / DM) + RMS_EPS);
#pragma unroll
            for (int j = 0; j < 4; ++j) xr[64 * j] = v[j] * rs * gv[j];
        }
    }
#undef IN
#undef SEAM
}

extern "C" void kernel_launch(void* const* d_in, const int* in_sizes, int n_in, void* d_out, int out_size, void* d_ws, size_t ws_size, hipStream_t stream) {
    static int grid = 0;
    if (grid == 0) {
        if (n_in != 13 || in_sizes[0] != M * DM || out_size != M * DM || ws_size < WS_END) { fprintf(stderr, "kernel_launch: unexpected shapes (n_in %d, in0 %d, out %d, ws %zu)\n", n_in, n_in > 0 ? in_sizes[0] : -1, out_size, ws_size); grid = -1; return; }
        int dev = 0, cus = 0, per_cu = 0;
        if (hipGetDevice(&dev) != hipSuccess || hipDeviceGetAttribute(&cus, hipDeviceAttributeMultiprocessorCount, dev) != hipSuccess) { grid = -1; return; }
        if (hipFuncSetAttribute((const void*)fwd_kernel, hipFuncAttributeMaxDynamicSharedMemorySize, LDS_BYTES) != hipSuccess) { fprintf(stderr, "kernel_launch: hipFuncSetAttribute failed\n"); grid = -1; return; }
        if (hipOccupancyMaxActiveBlocksPerMultiprocessor(&per_cu, (const void*)fwd_kernel, 512, LDS_BYTES) != hipSuccess || per_cu < 1) { fprintf(stderr, "kernel_launch: occupancy query says %d blocks per CU\n", per_cu); per_cu = 1; }
        (void)hipGetLastError();
        grid = cus;
        if (grid > 256) grid = 256;
    }
    if (grid < 0) return;
    (void)hipMemsetAsync((char*)d_ws + WS_CTL, 0, CTL_ZERO_BYTES, stream);
    Args a{};
    for (int i = 0; i < 13; ++i) a.in[i] = (const float*)d_in[i];
    a.out = (float*)d_out; a.ws = (unsigned char*)d_ws;
    if (N_LAUNCHES == 1) {
        a.ph_lo = 0; a.ph_hi = 7;
        void* kargs[] = {&a};
        hipError_t e = hipLaunchCooperativeKernel((const void*)fwd_kernel, dim3(grid), dim3(512), kargs, LDS_BYTES, stream);
        if (e != hipSuccess) fprintf(stderr, "kernel_launch: cooperative launch failed: %s (grid %d)\n", hipGetErrorString(e), grid);
    } else {
        for (int p = 0; p < 7; ++p) { a.ph_lo = p; a.ph_hi = p + 1; hipLaunchKernelGGL(fwd_kernel, dim3(grid), dim3(512), LDS_BYTES, stream, a); }
    }
}
```
